# Optimizing an MI355X kernel written in HIP

```python
import jax
import jax.numpy as jnp
from jax import lax
import numpy as np

D_MODEL = 1024
BATCH = 8
SEQ = 4096
DEPTH = 1

MIX_WIDTH = D_MODEL
ATT_WIDTH = MIX_WIDTH // 2
ATT_HEAD_DIM = 64
ATT_HEADS = ATT_WIDTH // ATT_HEAD_DIM
ROT_DIM = ATT_HEAD_DIM // 4
ROPE_THETA = 500000.0
MOBA_BLOCK = 256
MOBA_TOPK = 3
Q_CHUNK = 128
MLSTM_WIDTH = MIX_WIDTH - ATT_WIDTH
MLSTM_HEADS = 4
MLSTM_HEAD_DIM = MLSTM_WIDTH // MLSTM_HEADS
MLSTM_CHUNK = 64
CONV_WIDTH = 4
NORM_EPS = 1e-6
IN_SPLITS = (ATT_WIDTH,) * 4 + (MLSTM_WIDTH,) * 5 + (MLSTM_HEADS,) * 2

kernel_name = 'hybrid_moba_mlstm_block'


def rms_norm(x, g):
    xf = x.astype(jnp.float32)
    xf = xf * lax.rsqrt(jnp.mean(xf * xf, axis=-1, keepdims=True) + NORM_EPS)
    return xf.astype(x.dtype) * g


def split_columns(proj):
    idx = []
    acc = 0
    for s in IN_SPLITS[:-1]:
        acc += s
        idx.append(acc)
    return jnp.split(proj, idx, axis=-1)


def partial_rope(x, pos):
    half = ROT_DIM // 2
    inv_freq = jnp.power(ROPE_THETA, -jnp.arange(half, dtype=jnp.float32) * 2.0 / ROT_DIM)
    ang = pos.astype(jnp.float32)[:, None] * inv_freq[None, :]
    cos = jnp.cos(ang)[None, :, None, :].astype(x.dtype)
    sin = jnp.sin(ang)[None, :, None, :].astype(x.dtype)
    x1 = x[..., :half]
    x2 = x[..., half:ROT_DIM]
    return jnp.concatenate([x1 * cos - x2 * sin, x2 * cos + x1 * sin, x[..., ROT_DIM:]], axis=-1)


def causal_depthwise_conv(u, w, b):
    K = w.shape[0]
    S = u.shape[1]
    up = jnp.pad(u, ((0, 0), (K - 1, 0), (0, 0)))
    out = b
    for j in range(K):
        out = out + w[j] * up[:, j:j + S]
    return out


def moba_attention(q, k, v):
    B, S, H, dh = q.shape
    s_pad = -(-S // MOBA_BLOCK) * MOBA_BLOCK
    padw = ((0, 0), (0, s_pad - S), (0, 0), (0, 0))
    q = jnp.pad(q, padw) * (dh ** -0.5)
    k = jnp.pad(k, padw)
    v = jnp.pad(v, padw)
    nb = s_pad // MOBA_BLOCK
    nqc = s_pad // Q_CHUNK
    topk = min(MOBA_TOPK, nb)
    qc_per_block = MOBA_BLOCK // Q_CHUNK
    kb = k.reshape(B, nb, MOBA_BLOCK, H, dh).transpose(0, 3, 1, 2, 4)
    vb = v.reshape(B, nb, MOBA_BLOCK, H, dh).transpose(0, 3, 1, 2, 4)
    kmean = jnp.mean(kb.astype(jnp.float32), axis=3).astype(q.dtype)
    q_chunks = q.reshape(B, nqc, Q_CHUNK, H, dh).transpose(0, 1, 3, 2, 4).reshape(B * nqc, H, Q_CHUNK, dh)
    b_idx = jnp.repeat(jnp.arange(B, dtype=jnp.int32), nqc)
    c_idx = jnp.tile(jnp.arange(nqc, dtype=jnp.int32), B)
    h_ix = jnp.arange(H)[:, None, None]
    blk_ids = jnp.arange(nb)

    def one_chunk(args):
        q_c, b, c = args
        cur = c // qc_per_block
        k_b = kb[b]
        v_b = vb[b]
        gate = jnp.einsum('hqd,hnd->hqn', q_c, kmean[b]).astype(jnp.float32)
        gate = jnp.where(blk_ids < cur, gate, -jnp.inf)
        _, idx = lax.top_k(gate, topk)
        valid = idx < cur
        k_sel = k_b[h_ix, idx]
        v_sel = v_b[h_ix, idx]
        s_sel = jnp.einsum('hqd,hqjld->hqjl', q_c, k_sel).astype(jnp.float32)
        s_sel = jnp.where(valid[..., None], s_sel, -jnp.inf).reshape(H, Q_CHUNK, topk * MOBA_BLOCK)
        k_own = lax.dynamic_index_in_dim(k_b, cur, axis=1, keepdims=False)
        v_own = lax.dynamic_index_in_dim(v_b, cur, axis=1, keepdims=False)
        s_own = jnp.einsum('hqd,hld->hql', q_c, k_own).astype(jnp.float32)
        q_pos = c * Q_CHUNK + jnp.arange(Q_CHUNK)
        k_pos = cur * MOBA_BLOCK + jnp.arange(MOBA_BLOCK)
        s_own = jnp.where(k_pos[None, :] <= q_pos[:, None], s_own, -jnp.inf)
        p = jax.nn.softmax(jnp.concatenate([s_sel, s_own], axis=-1), axis=-1).astype(q_c.dtype)
        p_sel = p[..., :topk * MOBA_BLOCK].reshape(H, Q_CHUNK, topk, MOBA_BLOCK)
        p_own = p[..., topk * MOBA_BLOCK:]
        return (jnp.einsum('hqjl,hqjld->hqd', p_sel, v_sel)
                + jnp.einsum('hql,hld->hqd', p_own, v_own))

    out = lax.map(one_chunk, (q_chunks, b_idx, c_idx))
    out = out.reshape(B, nqc, H, Q_CHUNK, dh).transpose(0, 1, 3, 2, 4).reshape(B, s_pad, H * dh)
    return out[:, :S]


def mlstm_chunkwise(q, k, v, ig, fg):
    B, H, S, d = q.shape
    L = MLSTM_CHUNK
    nc = S // L
    q, k, v = (t.astype(jnp.float32) for t in (q, k, v))
    ig = ig.astype(jnp.float32)
    lf = jax.nn.log_sigmoid(fg.astype(jnp.float32))
    to_chunks = lambda t: jnp.moveaxis(t.reshape(B, H, nc, L, *t.shape[3:]), 2, 0)
    xs = (to_chunks(q), to_chunks(k), to_chunks(v), to_chunks(ig), to_chunks(lf))
    causal = jnp.tril(jnp.ones((L, L), dtype=bool))

    def step(carry, inp):
        C, n, m = carry
        qc, kc, vc, ic, fc = inp
        bcum = jnp.cumsum(fc, axis=-1)
        D = jnp.where(causal, bcum[..., :, None] - bcum[..., None, :] + ic[..., None, :], -jnp.inf)
        inter = bcum + m[..., None]
        m_t = jnp.maximum(inter, jnp.max(D, axis=-1))
        w_inter = jnp.exp(inter - m_t)
        s = jnp.einsum('bhtd,bhsd->bhts', qc, kc) * jnp.exp(D - m_t[..., None])
        num = (w_inter[..., None] * jnp.einsum('bhvd,bhtd->bhtv', C, qc)
               + jnp.einsum('bhts,bhsv->bhtv', s, vc))
        nq = w_inter * jnp.einsum('bhd,bhtd->bht', n, qc) + jnp.sum(s, axis=-1)
        h = num / jnp.maximum(jnp.abs(nq), jnp.exp(-m_t))[..., None]
        b_last = bcum[..., -1]
        g = b_last[..., None] - bcum + ic
        m_new = jnp.maximum(b_last + m, jnp.max(g, axis=-1))
        decay = jnp.exp(b_last + m - m_new)
        w = jnp.exp(g - m_new[..., None])
        C = decay[..., None, None] * C + jnp.einsum('bhs,bhsv,bhsd->bhvd', w, vc, kc)
        n = decay[..., None] * n + jnp.einsum('bhs,bhsd->bhd', w, kc)
        return (C, n, m_new), h

    init = (jnp.zeros((B, H, d, d), jnp.float32), jnp.zeros((B, H, d), jnp.float32),
            jnp.zeros((B, H), jnp.float32))
    _, hs = lax.scan(step, init, xs)
    return jnp.moveaxis(hs, 0, 2).reshape(B, H, S, d)


def setup_inputs(seed: int = 0) -> dict:
    key = jax.random.key(seed)
    ks = jax.random.split(key, 12)
    f32 = jnp.float32
    nrm = lambda k, shape: jax.random.normal(k, shape, f32)
    in_cols = sum(IN_SPLITS)
    return {
        'x': nrm(ks[0], (BATCH, SEQ, D_MODEL)),
        'pre_norm_g': 1.0 + 0.05 * nrm(ks[1], (DEPTH, D_MODEL)),
        'w_in': nrm(ks[2], (DEPTH, D_MODEL, in_cols)) * D_MODEL ** -0.5,
        'mlstm_i_bias': 0.1 * nrm(ks[3], (DEPTH, MLSTM_HEADS)),
        'mlstm_f_bias': jnp.linspace(3.0, 6.0, MLSTM_HEADS, dtype=f32)[None, :] + 0.01 * nrm(ks[4], (DEPTH, MLSTM_HEADS)),
        'conv_w': nrm(ks[5], (DEPTH, CONV_WIDTH, 2 * MLSTM_WIDTH)) * CONV_WIDTH ** -0.5,
        'conv_b': 0.01 * nrm(ks[6], (DEPTH, 2 * MLSTM_WIDTH)),
        'attn_out_g': 1.0 + 0.05 * nrm(ks[7], (DEPTH, ATT_WIDTH)),
        'mlstm_out_g': 1.0 + 0.05 * nrm(ks[8], (DEPTH, MLSTM_WIDTH)),
        'w_out': nrm(ks[9], (DEPTH, MIX_WIDTH, D_MODEL)) * MIX_WIDTH ** -0.5,
        'post_norm_g': 1.0 + 0.05 * nrm(ks[10], (DEPTH, D_MODEL)),
    }


def reference(x, pre_norm_g, w_in, mlstm_i_bias, mlstm_f_bias, conv_w, conv_b,
              attn_out_g, mlstm_out_g, w_out, post_norm_g):
    B, S, _ = x.shape
    pos = jnp.arange(S, dtype=jnp.int32)
    att_heads = lambda t: t.reshape(B, S, ATT_HEADS, ATT_HEAD_DIM)
    ml_heads = lambda t: t.reshape(B, S, MLSTM_HEADS, MLSTM_HEAD_DIM).transpose(0, 2, 1, 3)
    for l in range(DEPTH):
        h = rms_norm(x, pre_norm_g[l])
        proj = jnp.einsum('bsd,dc->bsc', h, w_in[l])
        aq, ak, av, az, mq, mk, mv, mo, mz, mi, mf = split_columns(proj)

        ya = moba_attention(partial_rope(att_heads(aq), pos), partial_rope(att_heads(ak), pos), att_heads(av))
        ya = rms_norm(ya, attn_out_g[l]) * jax.nn.silu(az)

        qk = jax.nn.silu(causal_depthwise_conv(jnp.concatenate([mq, mk], axis=-1), conv_w[l], conv_b[l]))
        mq_c, mk_c = jnp.split(qk, 2, axis=-1)
        hm = mlstm_chunkwise(ml_heads(mq_c), ml_heads(mk_c) * MLSTM_HEAD_DIM ** -0.5, ml_heads(mv),
                             (mi + mlstm_i_bias[l]).transpose(0, 2, 1),
                             (mf + mlstm_f_bias[l]).transpose(0, 2, 1))
        mu = jnp.mean(hm, axis=-1, keepdims=True)
        var = jnp.mean(jnp.square(hm - mu), axis=-1, keepdims=True)
        hm = (hm - mu) * lax.rsqrt(var + NORM_EPS)
        hm = hm.transpose(0, 2, 1, 3).reshape(B, S, MLSTM_WIDTH).astype(x.dtype) * mlstm_out_g[l]
        ym = jax.nn.sigmoid(mo) * hm * jax.nn.silu(mz)

        y = jnp.einsum('bsc,cd->bsd', jnp.concatenate([ya, ym], axis=-1), w_out[l])
        x = x + rms_norm(y, post_norm_g[l])
    return x
```

```cpp
#include <hip/hip_runtime.h>
#include <hip/hip_fp16.h>
#include <cstdio>
#include <cstdint>

namespace nv {
constexpr int B = 8, S = 4096, D = 1024, M = B * S;
constexpr int NC = 4616;
constexpr int AW = 512, AH = 8, HD = 64, ROT = 16;
constexpr int MBLK = 256, TOPK = 3, NB = S / MBLK;
constexpr int MW = 512, MH = 4, MD = 128;
constexpr float EPS = 1e-6f;
constexpr int C_AQ = 0, C_AK = 512, C_AV = 1024, C_AZ = 1536, C_MQ = 2048, C_MK = 2560, C_MV = 3072, C_MO = 3584, C_MZ = 4096, C_MI = 4608, C_MF = 4612;

constexpr size_t MiB = 1u << 20;
constexpr size_t WS_PROJ = 0;
constexpr size_t WS_GATES = 289 * MiB;
constexpr size_t WS_RSTD = 290 * MiB;
constexpr size_t WS_KMEAN = 290 * MiB + 512 * 1024;
constexpr size_t WS_YA = 292 * MiB;
constexpr size_t WS_HM = 356 * MiB;
constexpr size_t WS_YC = 420 * MiB;
constexpr size_t WS_END = 484 * MiB;

__device__ __forceinline__ float wave_sum(float v) {
#pragma unroll
    for (int o = 1; o < 64; o <<= 1) v += __shfl_xor(v, o);
    return v;
}
__device__ __forceinline__ float wave_max(float v) {
#pragma unroll
    for (int o = 1; o < 64; o <<= 1) v = fmaxf(v, __shfl_xor(v, o));
    return v;
}
__device__ __forceinline__ float silu(float x) { return x / (1.f + expf(-x)); }
__device__ __forceinline__ float sigmoidf(float x) { return 1.f / (1.f + expf(-x)); }

__global__ void k_rstd(const float* __restrict__ x, float* __restrict__ rstd) {
    const int row = blockIdx.x * 4 + (threadIdx.x >> 6), lane = threadIdx.x & 63;
    const float4* xr = (const float4*)(x + (size_t)row * D);
    float s = 0.f;
    for (int j = 0; j < 4; ++j) { float4 v = xr[lane + 64 * j]; s += v.x * v.x + v.y * v.y + v.z * v.z + v.w * v.w; }
    s = wave_sum(s);
    if (lane == 0) rstd[row] = 1.0f / sqrtf(s / D + EPS);
}

template <bool A_F32, bool OUT_PROJ>
__global__ void __launch_bounds__(256) k_gemm(const void* __restrict__ Ap, const float* __restrict__ rs, const float* __restrict__ cs,
                                              const float* __restrict__ Bm, int N, int K, __half* __restrict__ out16, float* __restrict__ gates, float* __restrict__ out32) {
    __shared__ float As[16][65];
    __shared__ float Bs[16][65];
    const int tid = threadIdx.x, tx = tid & 15, ty = tid >> 4;
    const int m0 = blockIdx.y * 64, n0 = blockIdx.x * 64;
    float acc[4][4];
#pragma unroll
    for (int i = 0; i < 4; ++i)
#pragma unroll
        for (int j = 0; j < 4; ++j) acc[i][j] = 0.f;
    for (int k0 = 0; k0 < K; k0 += 16) {
#pragma unroll
        for (int i = 0; i < 4; ++i) {
            const int e = tid + 256 * i, r = e >> 4, kk = e & 15;
            float a;
            if (A_F32) a = ((const float*)Ap)[(size_t)(m0 + r) * K + k0 + kk] * rs[m0 + r] * cs[k0 + kk];
            else a = __half2float(((const __half*)Ap)[(size_t)(m0 + r) * K + k0 + kk]);
            As[kk][r] = a;
        }
#pragma unroll
        for (int i = 0; i < 4; ++i) {
            const int e = tid + 256 * i, kk = e >> 6, c = e & 63;
            Bs[kk][c] = (n0 + c < N) ? Bm[(size_t)(k0 + kk) * N + n0 + c] : 0.f;
        }
        __syncthreads();
#pragma unroll
        for (int kk = 0; kk < 16; ++kk) {
            float a[4], b[4];
#pragma unroll
            for (int i = 0; i < 4; ++i) { a[i] = As[kk][ty * 4 + i]; b[i] = Bs[kk][tx * 4 + i]; }
#pragma unroll
            for (int i = 0; i < 4; ++i)
#pragma unroll
                for (int j = 0; j < 4; ++j) acc[i][j] = fmaf(a[i], b[j], acc[i][j]);
        }
        __syncthreads();
    }
#pragma unroll
    for (int i = 0; i < 4; ++i)
#pragma unroll
        for (int j = 0; j < 4; ++j) {
            const int m = m0 + ty * 4 + i, n = n0 + tx * 4 + j;
            if (n >= N) continue;
            if (OUT_PROJ) {
                out16[(size_t)m * N + n] = __float2half(acc[i][j]);
                if (n >= C_MI) gates[(size_t)m * 8 + (n - C_MI)] = acc[i][j];
            } else out32[(size_t)m * N + n] = acc[i][j];
        }
}

__global__ void k_rope(__half* __restrict__ proj) {
    const size_t gid = (size_t)blockIdx.x * blockDim.x + threadIdx.x;
    const int i = gid & 7, h = (gid >> 3) & 7, w = (gid >> 6) & 1; const size_t m = gid >> 7;
    if (m >= (size_t)M) return;
    const int pos = (int)(m % S);
    const float inv_freq = powf(500000.0f, -((float)i * 2.0f / 16.0f));
    const float ang = (float)pos * inv_freq;
    const float c = (float)cos((double)ang), s = (float)sin((double)ang);
    __half* p = proj + m * NC + (w ? C_AK : C_AQ) + h * HD;
    const float x1 = __half2float(p[i]), x2 = __half2float(p[i + 8]);
    p[i] = __float2half(x1 * c - x2 * s);
    p[i + 8] = __float2half(x2 * c + x1 * s);
}

__global__ void k_kmean(const __half* __restrict__ proj, float* __restrict__ kmean) {
    const int n = blockIdx.x % NB, h = (blockIdx.x / NB) % AH, b = blockIdx.x / (NB * AH), d = threadIdx.x;
    float s = 0.f;
    for (int r = 0; r < MBLK; ++r) s += __half2float(proj[(size_t)(b * S + n * MBLK + r) * NC + C_AK + h * HD + d]);
    kmean[(size_t)blockIdx.x * 64 + d] = s * (1.0f / MBLK);
}

__global__ void __launch_bounds__(256) k_moba(const __half* __restrict__ proj, const float* __restrict__ kmean, float* __restrict__ ya) {
    const int wid = threadIdx.x >> 6, lane = threadIdx.x & 63;
    const size_t gw = (size_t)blockIdx.x * 4 + wid;
    const int h = gw & 7; const size_t m = gw >> 3;
    const int b = (int)(m / S), pos = (int)(m % S), cur = pos / MBLK;
    const __half* qp = proj + m * NC + C_AQ + h * HD;
    float q[64];
#pragma unroll
    for (int d = 0; d < 64; ++d) q[d] = __half2float(qp[d]) * 0.125f;
    float gate = -INFINITY;
    if (lane < cur) { const float* km = kmean + ((size_t)(b * AH + h) * NB + lane) * 64; float s = 0.f;
#pragma unroll
        for (int d = 0; d < 64; ++d) s = fmaf(q[d], km[d], s); gate = s; }
    int sel[3] = {-1, -1, -1};
    float g = gate;
#pragma unroll
    for (int k = 0; k < TOPK; ++k) {
        const float mxg = wave_max(g);
        if (mxg != -INFINITY) {
            const unsigned long long bal = __ballot(g == mxg);
            const int idx = __ffsll((long long)bal) - 1;
            sel[k] = idx;
            if (lane == idx) g = -INFINITY;
        }
    }
    float sc[16];
    const __half* kbase = proj + (size_t)b * S * NC + C_AK + h * HD;
    const __half* vbase = proj + (size_t)b * S * NC + C_AV + h * HD;
    float mx = -INFINITY;
#pragma unroll
    for (int jb = 0; jb < 4; ++jb) {
        const bool own = (jb == 3); const int sj = sel[jb < 3 ? jb : 0]; const bool act = own || (sj >= 0);
        const int blk = own ? cur : (sj >= 0 ? sj : 0);
#pragma unroll
        for (int i = 0; i < 4; ++i) {
            const int kp = blk * MBLK + lane + 64 * i;
            float s = -INFINITY;
            if (act && (!own || kp <= pos)) {
                const __half* kr = kbase + (size_t)kp * NC; s = 0.f;
#pragma unroll
                for (int d = 0; d < 64; ++d) s = fmaf(q[d], __half2float(kr[d]), s);
            }
            sc[jb * 4 + i] = s; mx = fmaxf(mx, s);
        }
    }
    mx = wave_max(mx);
    float l = 0.f; float acc[64];
#pragma unroll
    for (int d = 0; d < 64; ++d) acc[d] = 0.f;
#pragma unroll
    for (int jb = 0; jb < 4; ++jb) {
        const bool own = (jb == 3); const int sj = sel[jb < 3 ? jb : 0];
        const int blk = own ? cur : (sj >= 0 ? sj : 0);
#pragma unroll
        for (int i = 0; i < 4; ++i) {
            const float s = sc[jb * 4 + i];
            if (s != -INFINITY) {
                const float p = expf(s - mx); l += p;
                const int kp = blk * MBLK + lane + 64 * i;
                const __half* vr = vbase + (size_t)kp * NC;
#pragma unroll
                for (int d = 0; d < 64; ++d) acc[d] = fmaf(p, __half2float(vr[d]), acc[d]);
            }
        }
    }
    l = wave_sum(l);
    float outv = 0.f;
#pragma unroll
    for (int d = 0; d < 64; ++d) { const float t = wave_sum(acc[d]); if (lane == d) outv = t; }
    ya[m * AW + h * HD + lane] = outv / l;
}

__global__ void __launch_bounds__(128) k_mlstm(const __half* __restrict__ proj, const float* __restrict__ gates, const float* __restrict__ ib, const float* __restrict__ fb,
                                               const float* __restrict__ cw, const float* __restrict__ cb, float* __restrict__ hm) {
    __shared__ float red[2][2][8];
    const int vt = blockIdx.x & 31, h = (blockIdx.x >> 5) & 3, b = blockIdx.x >> 7;
    const int d = threadIdx.x, wv = d >> 6, lane = d & 63;
    const int cq = h * MD + d, ck = 512 + h * MD + d;
    float wq[4], wk[4];
#pragma unroll
    for (int j = 0; j < 4; ++j) { wq[j] = cw[j * 1024 + cq]; wk[j] = cw[j * 1024 + ck]; }
    const float bq = cb[cq], bk = cb[ck];
    const float ibias = ib[h], fbias = fb[h];
    float C[4] = {0.f, 0.f, 0.f, 0.f}, n = 0.f, mst = 0.f;
    float hq[3] = {0.f, 0.f, 0.f}, hk[3] = {0.f, 0.f, 0.f};
    const __half* pr = proj + (size_t)b * S * NC;
    const float* gt = gates + (size_t)b * S * 8;
    for (int t = 0; t < S; ++t) {
        const __half* row = pr + (size_t)t * NC;
        const float rq = __half2float(row[C_MQ + h * MD + d]), rk = __half2float(row[C_MK + h * MD + d]);
        float v[4];
#pragma unroll
        for (int j = 0; j < 4; ++j) v[j] = __half2float(row[C_MV + h * MD + vt * 4 + j]);
        const float ig = gt[t * 8 + h] + ibias, fg = gt[t * 8 + 4 + h] + fbias;
        const float lf = fminf(fg, 0.f) - log1pf(expf(-fabsf(fg)));
        float qc = bq + wq[0] * hq[0] + wq[1] * hq[1] + wq[2] * hq[2] + wq[3] * rq;
        float kc = bk + wk[0] * hk[0] + wk[1] * hk[1] + wk[2] * hk[2] + wk[3] * rk;
        hq[0] = hq[1]; hq[1] = hq[2]; hq[2] = rq; hk[0] = hk[1]; hk[1] = hk[2]; hk[2] = rk;
        qc = silu(qc); kc = silu(kc) * 0.08838834764831845f;
        const float mnew = fmaxf(lf + mst, ig);
        const float fd = expf(lf + mst - mnew), id = expf(ig - mnew);
        mst = mnew;
        float p[5];
#pragma unroll
        for (int j = 0; j < 4; ++j) { C[j] = fd * C[j] + id * v[j] * kc; p[j] = C[j] * qc; }
        n = fd * n + id * kc; p[4] = n * qc;
#pragma unroll
        for (int j = 0; j < 5; ++j) p[j] = wave_sum(p[j]);
        const int bf = t & 1;
        if (lane == 0) {
#pragma unroll
            for (int j = 0; j < 5; ++j) red[bf][wv][j] = p[j];
        }
        __syncthreads();
        if (d < 4) {
            const float num = red[bf][0][d] + red[bf][1][d], nq = red[bf][0][4] + red[bf][1][4];
            hm[(size_t)(b * S + t) * MW + h * MD + vt * 4 + d] = num / fmaxf(fabsf(nq), expf(-mst));
        }
    }
}

__global__ void __launch_bounds__(256) k_mix(const __half* __restrict__ proj, const float* __restrict__ ya, const float* __restrict__ hm, const float* __restrict__ ag, const float* __restrict__ mg, __half* __restrict__ yc) {
    const int wid = threadIdx.x >> 6, lane = threadIdx.x & 63;
    const size_t m = (size_t)blockIdx.x * 4 + wid;
    const __half* row = proj + m * NC;
    float a[8]; float ss = 0.f;
#pragma unroll
    for (int j = 0; j < 8; ++j) { a[j] = ya[m * AW + lane + 64 * j]; ss += a[j] * a[j]; }
    ss = wave_sum(ss);
    const float r = 1.0f / sqrtf(ss / AW + EPS);
#pragma unroll
    for (int j = 0; j < 8; ++j) { const int c = lane + 64 * j; yc[m * 1024 + c] = __float2half(a[j] * r * ag[c] * silu(__half2float(row[C_AZ + c]))); }
#pragma unroll
    for (int hh = 0; hh < 4; ++hh) {
        const float v0 = hm[m * MW + hh * MD + lane], v1 = hm[m * MW + hh * MD + 64 + lane];
        const float mu = wave_sum(v0 + v1) * (1.0f / MD);
        const float d0 = v0 - mu, d1 = v1 - mu;
        const float var = wave_sum(d0 * d0 + d1 * d1) * (1.0f / MD);
        const float rr = 1.0f / sqrtf(var + EPS);
        const int c0 = hh * MD + lane, c1 = c0 + 64;
        yc[m * 1024 + 512 + c0] = __float2half(d0 * rr * mg[c0] * sigmoidf(__half2float(row[C_MO + c0])) * silu(__half2float(row[C_MZ + c0])));
        yc[m * 1024 + 512 + c1] = __float2half(d1 * rr * mg[c1] * sigmoidf(__half2float(row[C_MO + c1])) * silu(__half2float(row[C_MZ + c1])));
    }
}

__global__ void k_final(const float* __restrict__ x, const float* __restrict__ g, float* __restrict__ out) {
    const int row = blockIdx.x * 4 + (threadIdx.x >> 6), lane = threadIdx.x & 63;
    float4* yr = (float4*)(out + (size_t)row * D); const float4* xr = (const float4*)(x + (size_t)row * D); const float4* gr = (const float4*)g;
    float4 v[4]; float s = 0.f;
    for (int j = 0; j < 4; ++j) { v[j] = yr[lane + 64 * j]; s += v[j].x * v[j].x + v[j].y * v[j].y + v[j].z * v[j].z + v[j].w * v[j].w; }
    s = wave_sum(s);
    const float r = 1.0f / sqrtf(s / D + EPS);
    for (int j = 0; j < 4; ++j) { const float4 xx = xr[lane + 64 * j], gg = gr[lane + 64 * j]; float4 o;
        o.x = xx.x + v[j].x * r * gg.x; o.y = xx.y + v[j].y * r * gg.y; o.z = xx.z + v[j].z * r * gg.z; o.w = xx.w + v[j].w * r * gg.w; yr[lane + 64 * j] = o; }
}
}

extern "C" void kernel_launch(void* const* d_in, const int* in_sizes, int n_in, void* d_out, int out_size, void* d_ws, size_t ws_size, hipStream_t stream) {
    using namespace nv;
    if (ws_size < WS_END) { fprintf(stderr, "ws too small: %zu\n", ws_size); return; }
    const float* x = (const float*)d_in[0]; const float* pre_g = (const float*)d_in[1]; const float* w_in = (const float*)d_in[2];
    const float* ib = (const float*)d_in[3]; const float* fb = (const float*)d_in[4]; const float* cw = (const float*)d_in[5]; const float* cb = (const float*)d_in[6];
    const float* ag = (const float*)d_in[7]; const float* mg = (const float*)d_in[8]; const float* w_out = (const float*)d_in[9]; const float* post_g = (const float*)d_in[10];
    unsigned char* ws = (unsigned char*)d_ws;
    __half* proj = (__half*)(ws + WS_PROJ); float* gates = (float*)(ws + WS_GATES); float* rstd = (float*)(ws + WS_RSTD); float* kmean = (float*)(ws + WS_KMEAN);
    float* ya = (float*)(ws + WS_YA); float* hm = (float*)(ws + WS_HM); __half* yc = (__half*)(ws + WS_YC); float* out = (float*)d_out;
    k_rstd<<<M / 4, 256, 0, stream>>>(x, rstd);
    k_gemm<true, true><<<dim3((NC + 63) / 64, M / 64), 256, 0, stream>>>(x, rstd, pre_g, w_in, NC, D, proj, gates, nullptr);
    k_rope<<<(M * 128) / 256, 256, 0, stream>>>(proj);
    k_kmean<<<B * AH * NB, 64, 0, stream>>>(proj, kmean);
    k_moba<<<(M * AH) / 4, 256, 0, stream>>>(proj, kmean, ya);
    k_mlstm<<<B * MH * 32, 128, 0, stream>>>(proj, gates, ib, fb, cw, cb, hm);
    k_mix<<<M / 4, 256, 0, stream>>>(proj, ya, hm, ag, mg, yc);
    k_gemm<false, false><<<dim3(D / 64, M / 64), 256, 0, stream>>>(yc, nullptr, nullptr, w_out, D, D, nullptr, nullptr, out);
    k_final<<<M / 4, 256, 0, stream>>>(x, post_g, out);
}
```
